# Optimizing an MI355X kernel written in HIP

```python
import math
import jax, jax.numpy as jnp
from jax import lax
import numpy as np

D_MODEL = 1024
BATCH = 4
SEQ = 8192
DEPTH = 1

N_ATTN_HEADS = 8
HEAD_DIM = 64
ATTN_WIDTH = N_ATTN_HEADS * HEAD_DIM
ROT_DIM = HEAD_DIM // 4
ROPE_THETA = 500000.0
MOBA_BLOCK = 256
MOBA_TOP_K = 3
Q_CHUNK = 64
SSM_WIDTH = D_MODEL // 2
SSM_GROUP = 16
N_SSM_GROUPS = SSM_WIDTH // SSM_GROUP
SSM_STATE = 64
DT_MIN = 1e-3
DT_MAX = 1e-1
D_FF = 2816
CONV_WIDTH = 3
IN_WIDTH = 3 * ATTN_WIDTH + SSM_WIDTH + 2 * D_MODEL
LN_EPS = 1e-5
DEEPNORM_ALPHA = (2.0 * DEPTH) ** 0.25
DEEPNORM_BETA = (8.0 * DEPTH) ** -0.25
NEG_INF = -1e30

kernel_name = 'moba_s5_gated_hybrid_deepnorm_block'


def layer_norm(t, g, b):
    tf = t.astype(jnp.float32)
    mu = jnp.mean(tf, axis=-1, keepdims=True)
    var = jnp.mean(jnp.square(tf - mu), axis=-1, keepdims=True)
    y = (tf - mu) * lax.rsqrt(var + LN_EPS) * g.astype(jnp.float32) + b.astype(jnp.float32)
    return y.astype(t.dtype)


def rotary_tables(seq_len):
    inv_freq = ROPE_THETA ** (-jnp.arange(0, ROT_DIM, 2, dtype=jnp.float32) / ROT_DIM)
    pos = jnp.arange(seq_len, dtype=jnp.float32)
    ang = pos[:, None] * inv_freq[None, :]
    return jnp.cos(ang), jnp.sin(ang)


def apply_partial_rotary(t, cos, sin):
    half = ROT_DIM // 2
    r1 = t[..., :half]
    r2 = t[..., half:ROT_DIM]
    rest = t[..., ROT_DIM:]
    c = cos[None, :, None, :].astype(t.dtype)
    s = sin[None, :, None, :].astype(t.dtype)
    return jnp.concatenate([r1 * c - r2 * s, r1 * s + r2 * c, rest], axis=-1)


def moba_attention(q, k, v):
    bsz, seq, n_heads, dh = q.shape
    n_blocks = -(-seq // MOBA_BLOCK)
    seq_pad = n_blocks * MOBA_BLOCK
    pad = ((0, 0), (0, 0), (0, seq_pad - seq), (0, 0))
    qh = jnp.pad(q.transpose(0, 2, 1, 3), pad)
    kh = jnp.pad(k.transpose(0, 2, 1, 3), pad)
    vh = jnp.pad(v.transpose(0, 2, 1, 3), pad)
    kb = kh.reshape(bsz, n_heads, n_blocks, MOBA_BLOCK, dh)
    vb = vh.reshape(bsz, n_heads, n_blocks, MOBA_BLOCK, dh)
    k_mean = jnp.mean(kb.astype(jnp.float32), axis=3)
    top_k = min(MOBA_TOP_K, n_blocks)
    n_sel = top_k + 1
    b_idx = jnp.arange(bsz)[:, None, None, None]
    h_idx = jnp.arange(n_heads)[None, :, None, None]
    blk_ids = jnp.arange(n_blocks)
    k_offs = jnp.arange(MOBA_BLOCK)
    q_offs = jnp.arange(Q_CHUNK)
    scale = dh ** -0.5

    def one_chunk(ci):
        q0 = ci * Q_CHUNK
        own = q0 // MOBA_BLOCK
        qc = lax.dynamic_slice_in_dim(qh, q0, Q_CHUNK, axis=2)
        gate = jnp.einsum('bhqd,bhnd->bhqn', qc.astype(jnp.float32), k_mean)
        gate = jnp.where(blk_ids < own, gate, NEG_INF)
        _, sel = lax.top_k(gate, top_k)
        sel_valid = sel < own
        own_idx = jnp.broadcast_to(own, sel.shape[:-1] + (1,)).astype(sel.dtype)
        idx = jnp.concatenate([sel, own_idx], axis=-1)
        kg = kb[b_idx, h_idx, idx]
        vg = vb[b_idx, h_idx, idx]
        s = jnp.einsum('bhqd,bhqnkd->bhqnk', qc, kg, preferred_element_type=jnp.float32) * scale
        causal = (own * MOBA_BLOCK + k_offs)[None, :] <= (q0 + q_offs)[:, None]
        mask = jnp.concatenate([
            jnp.broadcast_to(sel_valid[..., None], sel.shape + (MOBA_BLOCK,)),
            jnp.broadcast_to(causal[None, None, :, None, :], (bsz, n_heads, Q_CHUNK, 1, MOBA_BLOCK)),
        ], axis=3)
        s = jnp.where(mask, s, NEG_INF)
        p = jax.nn.softmax(s.reshape(bsz, n_heads, Q_CHUNK, n_sel * MOBA_BLOCK), axis=-1)
        vflat = vg.reshape(bsz, n_heads, Q_CHUNK, n_sel * MOBA_BLOCK, dh)
        return jnp.einsum('bhqm,bhqmd->bhqd', p.astype(vflat.dtype), vflat)

    out = lax.map(one_chunk, jnp.arange(seq_pad // Q_CHUNK))
    out = out.transpose(1, 2, 0, 3, 4).reshape(bsz, n_heads, seq_pad, dh)[:, :, :seq]
    return out.transpose(0, 2, 1, 3).reshape(bsz, seq, n_heads * dh)


def s5_branch(u, a_re, a_im, log_dt, b_re, b_im, c_re, c_im, d_skip, w_glu):
    bsz, seq, _ = u.shape
    f32 = jnp.float32
    uf = u.astype(f32).reshape(bsz, seq, N_SSM_GROUPS, SSM_GROUP)
    a_re = a_re.astype(f32)
    a_im = a_im.astype(f32)
    dt = jnp.exp(log_dt.astype(f32))[:, None]
    mag = jnp.exp(a_re * dt)
    lb_re = mag * jnp.cos(a_im * dt)
    lb_im = mag * jnp.sin(a_im * dt)
    den = a_re * a_re + a_im * a_im
    n_re = lb_re - 1.0
    n_im = lb_im
    z_re = (n_re * a_re + n_im * a_im) / den
    z_im = (n_im * a_re - n_re * a_im) / den
    bu_re = jnp.einsum('gph,bsgh->bsgp', b_re.astype(f32), uf)
    bu_im = jnp.einsum('gph,bsgh->bsgp', b_im.astype(f32), uf)
    x_re = z_re * bu_re - z_im * bu_im
    x_im = z_re * bu_im + z_im * bu_re
    a_el_re = jnp.broadcast_to(lb_re, (1, seq, N_SSM_GROUPS, SSM_STATE))
    a_el_im = jnp.broadcast_to(lb_im, (1, seq, N_SSM_GROUPS, SSM_STATE))

    def combine(e1, e2):
        a1r, a1i, b1r, b1i = e1
        a2r, a2i, b2r, b2i = e2
        return (a2r * a1r - a2i * a1i,
                a2r * a1i + a2i * a1r,
                a2r * b1r - a2i * b1i + b2r,
                a2r * b1i + a2i * b1r + b2i)

    _, _, h_re, h_im = lax.associative_scan(combine, (a_el_re, a_el_im, x_re, x_im), axis=1)
    y = (jnp.einsum('ghp,bsgp->bsgh', c_re.astype(f32), h_re)
         - jnp.einsum('ghp,bsgp->bsgh', c_im.astype(f32), h_im)
         + d_skip.astype(f32) * uf)
    y = jax.nn.gelu(y.reshape(bsz, seq, SSM_WIDTH))
    y = y * jax.nn.sigmoid(y @ w_glu.astype(f32))
    return y.astype(u.dtype)


def causal_depthwise_conv(t, w, b):
    seq = t.shape[1]
    tp = jnp.pad(t, ((0, 0), (CONV_WIDTH - 1, 0), (0, 0)))
    out = b + tp[:, 0:seq, :] * w[0]
    for j in range(1, CONV_WIDTH):
        out = out + tp[:, j:j + seq, :] * w[j]
    return out


def setup_inputs(seed: int = 0) -> dict:
    key = jax.random.key(seed)
    ks = jax.random.split(key, 24)
    f32 = jnp.float32
    L = DEPTH

    def dense(k, fan_in, fan_out, scale=1.0):
        return jax.random.normal(k, (L, fan_in, fan_out), f32) * (scale * fan_in ** -0.5)

    x = jax.random.normal(ks[0], (BATCH, SEQ, D_MODEL), f32)
    col_scale = jnp.concatenate([
        jnp.ones((2 * ATTN_WIDTH,), f32),
        jnp.full((ATTN_WIDTH + SSM_WIDTH,), DEEPNORM_BETA, f32),
        jnp.ones((2 * D_MODEL,), f32)])
    w_in = dense(ks[1], D_MODEL, IN_WIDTH) * col_scale
    w_attn_proj = dense(ks[2], ATTN_WIDTH, D_MODEL)
    n = jnp.arange(SSM_STATE, dtype=f32)
    gp = (L, N_SSM_GROUPS, SSM_STATE)
    ssm_a_re = -0.5 + 0.01 * jax.random.normal(ks[3], gp, f32)
    ssm_a_im = math.pi * n + 0.01 * jax.random.normal(ks[4], gp, f32)
    ssm_log_dt = jax.random.uniform(ks[5], (L, N_SSM_GROUPS), f32,
                                    minval=math.log(DT_MIN), maxval=math.log(DT_MAX))
    bshape = (L, N_SSM_GROUPS, SSM_STATE, SSM_GROUP)
    cshape = (L, N_SSM_GROUPS, SSM_GROUP, SSM_STATE)
    bscale = (2.0 * SSM_GROUP) ** -0.5
    cscale = (2.0 * SSM_STATE) ** -0.5
    ssm_b_re = jax.random.normal(ks[6], bshape, f32) * bscale
    ssm_b_im = jax.random.normal(ks[7], bshape, f32) * bscale
    ssm_c_re = jax.random.normal(ks[8], cshape, f32) * cscale
    ssm_c_im = jax.random.normal(ks[9], cshape, f32) * cscale
    ssm_d = jax.random.normal(ks[10], (L, N_SSM_GROUPS, SSM_GROUP), f32)
    w_glu = dense(ks[11], SSM_WIDTH, SSM_WIDTH)
    w_ssm_proj = dense(ks[12], SSM_WIDTH, D_MODEL)
    w_out = dense(ks[13], D_MODEL, D_MODEL, DEEPNORM_BETA)
    ln1_g = 1.0 + 0.02 * jax.random.normal(ks[14], (L, D_MODEL), f32)
    ln1_b = 0.02 * jax.random.normal(ks[15], (L, D_MODEL), f32)
    w_up = dense(ks[16], D_MODEL, 2 * D_FF, DEEPNORM_BETA)
    conv_w = jax.random.normal(ks[17], (L, CONV_WIDTH, 2 * D_FF), f32) * CONV_WIDTH ** -0.5
    conv_b = 0.01 * jax.random.normal(ks[18], (L, 2 * D_FF), f32)
    w_down = dense(ks[19], D_FF, D_MODEL, DEEPNORM_BETA)
    ln2_g = 1.0 + 0.02 * jax.random.normal(ks[20], (L, D_MODEL), f32)
    ln2_b = 0.02 * jax.random.normal(ks[21], (L, D_MODEL), f32)
    return {'x': x, 'w_in': w_in, 'w_attn_proj': w_attn_proj,
            'ssm_a_re': ssm_a_re, 'ssm_a_im': ssm_a_im, 'ssm_log_dt': ssm_log_dt,
            'ssm_b_re': ssm_b_re, 'ssm_b_im': ssm_b_im, 'ssm_c_re': ssm_c_re, 'ssm_c_im': ssm_c_im,
            'ssm_d': ssm_d, 'w_glu': w_glu, 'w_ssm_proj': w_ssm_proj, 'w_out': w_out,
            'ln1_g': ln1_g, 'ln1_b': ln1_b, 'w_up': w_up, 'conv_w': conv_w, 'conv_b': conv_b,
            'w_down': w_down, 'ln2_g': ln2_g, 'ln2_b': ln2_b}


def reference(x, w_in, w_attn_proj, ssm_a_re, ssm_a_im, ssm_log_dt, ssm_b_re, ssm_b_im,
              ssm_c_re, ssm_c_im, ssm_d, w_glu, w_ssm_proj, w_out, ln1_g, ln1_b,
              w_up, conv_w, conv_b, w_down, ln2_g, ln2_b):
    bsz, seq, _ = x.shape
    cos, sin = rotary_tables(seq)
    splits = np.cumsum([ATTN_WIDTH, ATTN_WIDTH, ATTN_WIDTH, SSM_WIDTH, D_MODEL])
    h = x
    for l in range(DEPTH):
        proj = h @ w_in[l]
        q, k, v, u, g_attn, g_ssm = jnp.split(proj, splits, axis=-1)
        q = apply_partial_rotary(q.reshape(bsz, seq, N_ATTN_HEADS, HEAD_DIM), cos, sin)
        k = apply_partial_rotary(k.reshape(bsz, seq, N_ATTN_HEADS, HEAD_DIM), cos, sin)
        v = v.reshape(bsz, seq, N_ATTN_HEADS, HEAD_DIM)
        attn = moba_attention(q, k, v)
        ssm = s5_branch(u, ssm_a_re[l], ssm_a_im[l], ssm_log_dt[l], ssm_b_re[l], ssm_b_im[l],
                        ssm_c_re[l], ssm_c_im[l], ssm_d[l], w_glu[l])
        merged = (jax.nn.sigmoid(g_attn) * (attn @ w_attn_proj[l])
                  + jax.nn.sigmoid(g_ssm) * (ssm @ w_ssm_proj[l]))
        mix = merged @ w_out[l]
        h = layer_norm(DEEPNORM_ALPHA * h + mix, ln1_g[l], ln1_b[l])
        up = causal_depthwise_conv(h @ w_up[l], conv_w[l], conv_b[l])
        val, gate = jnp.split(up, 2, axis=-1)
        ff = (jax.nn.gelu(gate) * val) @ w_down[l]
        h = layer_norm(DEEPNORM_ALPHA * h + ff, ln2_g[l], ln2_b[l])
    return h
```

```cpp
#include <hip/hip_runtime.h>
#include <hip/hip_cooperative_groups.h>
#include <cstdio>
#include <cstdint>
namespace cg = cooperative_groups;

#define LAS __attribute__((address_space(3)))
typedef unsigned short bf16;
typedef short bf16x8 __attribute__((ext_vector_type(8)));
typedef float f32x4 __attribute__((ext_vector_type(4)));
typedef float f32x2 __attribute__((ext_vector_type(2)));
typedef float f32x16 __attribute__((ext_vector_type(16)));
typedef unsigned u32x4 __attribute__((ext_vector_type(4)));
typedef unsigned u32x2 __attribute__((ext_vector_type(2)));
typedef __bf16 bf16x2_t __attribute__((ext_vector_type(2)));

constexpr int NB = 4, SEQ = 8192, M = NB * SEQ, D = 1024, AW = 512, NH = 8, HD = 64, SW = 512, NG = 32, NP = 64, FF = 2816, FF2 = 5632, INW = 4096;
constexpr int NBLK = 32;
constexpr int LC = 16, NCH = SEQ / LC;
constexpr int UROW = 384;
constexpr int HALFM = M / 2;
constexpr float LN_EPS = 1e-5f;
constexpr float ALPHA = 1.189207115002721f;

constexpr size_t MiB = 1u << 20;
constexpr size_t WS_CTL = 0, CTL_BYTES = 1 * MiB;
constexpr size_t WS_ROPE = 1 * MiB;
constexpr size_t WS_KMEAN = 1 * MiB + 512 * 1024;
constexpr size_t WS_LBPOW = 2 * MiB;
constexpr size_t WS_ZB = 2 * MiB + 512 * 1024;
constexpr size_t WS_SEL = 3 * MiB;
constexpr size_t WS_WIN = 4 * MiB, WS_WAP = 12 * MiB, WS_WGLU = 13 * MiB, WS_WSP = 13 * MiB + 512 * 1024, WS_WOUT = 14 * MiB + 512 * 1024;
constexpr size_t WS_WUP = 16 * MiB + 512 * 1024, WS_WDN = 27 * MiB + 512 * 1024, WS_WE = 33 * MiB, WS_WY = 37 * MiB, WS_LSE = 43 * MiB;
constexpr size_t WS_GA = 48 * MiB, WS_GS = 112 * MiB, WS_Q = 176 * MiB, WS_K = 208 * MiB, WS_VT = 240 * MiB, WS_UA = 272 * MiB, WS_XB = 320 * MiB, WS_E = 384 * MiB, WS_Y = 448 * MiB;
constexpr size_t WS_PBUF = 320 * MiB;
constexpr size_t WS_ATT = 272 * MiB;
constexpr size_t WS_SSMO = 176 * MiB;
constexpr size_t WS_MERGED = 208 * MiB;
constexpr size_t WS_H1B = 320 * MiB;
constexpr size_t WS_UPH = 48 * MiB;
constexpr size_t WS_ACTH = 384 * MiB;
constexpr size_t WS_END = 480 * MiB;
constexpr int CW_ATTQ = 64, CW_LN1 = 1024, CW_LN2 = 16384;

constexpr int RING_BYTES = 131072, MISC_OFF = RING_BYTES, LDS_BYTES = 147456;
constexpr int KS_STRIDE = 144, VS_STRIDE = 528, LDS_KS = 0, LDS_VS = 256 * KS_STRIDE, LDS_LIST = LDS_VS + 64 * VS_STRIDE;

__device__ __forceinline__ unsigned cvtpk(float lo, float hi) { f32x2 v = {lo, hi}; bf16x2_t b = __builtin_convertvector(v, bf16x2_t); return __builtin_bit_cast(unsigned, b); }
__device__ __forceinline__ bf16 f2bf(float f) { return (bf16)(cvtpk(f, 0.f) & 0xffffu); }
__device__ __forceinline__ float bflo(unsigned u) { return __uint_as_float(u << 16); }
__device__ __forceinline__ float bfhi(unsigned u) { return __uint_as_float(u & 0xffff0000u); }
__device__ __forceinline__ float bf2f(bf16 b) { return __uint_as_float((unsigned)b << 16); }
__device__ __forceinline__ float fsigmoid(float x) { return 1.0f / (1.0f + __expf(-x)); }
__device__ __forceinline__ float gelu_tanh(float x) { const float u = 1.5957691216057308f * (x + 0.044715f * x * x * x); return x / (1.0f + __expf(-u)); }
__device__ __forceinline__ void unpack8(u32x4 w, float* f) { f[0] = bflo(w.x); f[1] = bfhi(w.x); f[2] = bflo(w.y); f[3] = bfhi(w.y); f[4] = bflo(w.z); f[5] = bfhi(w.z); f[6] = bflo(w.w); f[7] = bfhi(w.w); }
__device__ __forceinline__ u32x4 pack8(const float* f) { u32x4 w; w.x = cvtpk(f[0], f[1]); w.y = cvtpk(f[2], f[3]); w.z = cvtpk(f[4], f[5]); w.w = cvtpk(f[6], f[7]); return w; }
__device__ __forceinline__ void dsincos(double a, double& s, double& c) {
    const double q = rint(a * 0.63661977236758134308);
    const double r = (a - q * 1.5707963267948966192) - q * 6.123233995736766e-17;
    const double r2 = r * r;
    double sp = -7.6471637318198164759e-13;
    sp = sp * r2 + 1.6059043836821614599e-10; sp = sp * r2 - 2.5052108385441718775e-08; sp = sp * r2 + 2.7557319223985890653e-06;
    sp = sp * r2 - 1.9841269841269841270e-04; sp = sp * r2 + 8.3333333333333333333e-03; sp = sp * r2 - 1.6666666666666666667e-01;
    const double sr = r + r * r2 * sp;
    double cp = 4.7794773323873852974e-14;
    cp = cp * r2 - 1.1470745597729724714e-11; cp = cp * r2 + 2.0876756987868098979e-09; cp = cp * r2 - 2.7557319223985890653e-07;
    cp = cp * r2 + 2.4801587301587301587e-05; cp = cp * r2 - 1.3888888888888888889e-03; cp = cp * r2 + 4.1666666666666666667e-02; cp = cp * r2 - 0.5;
    const double cr = 1.0 + r2 * cp;
    const long qi = (long)q; const int qq = (int)(qi & 3);
    s = (qq == 0) ? sr : (qq == 1) ? cr : (qq == 2) ? -sr : -cr;
    c = (qq == 0) ? cr : (qq == 1) ? -sr : (qq == 2) ? -cr : sr;
}

namespace pg8 {
constexpr int BM = 256, BK = 64, HALF = 128, HTB = HALF * BK * 2, STAGE_BYTES = 8 * HTB, NXCD = 8, WGM = 8;
__host__ __device__ __forceinline__ int lds_byte(int r, int c) { const int st = (r >> 4) * 2 + (c >> 5), rr = r & 15, cc = c & 31, ob = rr * 64 + cc * 2; return st * 1024 + (ob ^ (((ob >> 9) & 1) << 5)); }
__host__ __device__ __forceinline__ void stage_rc(int b, int& R, int& C) { const int st = b / 1024, sb = b % 1024, swz = sb ^ (((sb >> 9) & 1) << 5); R = (st >> 1) * 16 + swz / 64; C = (st & 1) * 32 + (swz % 64) / 2; }
__host__ __device__ __forceinline__ int perm32(int rho) { const int n = rho >> 4, i = rho & 15; return 8 * (i >> 2) + 4 * n + (i & 3); }

struct Unit { int pm, pn, tag; long aoff, boff; };
struct Gemm { const char* A; const char* Bt; int K, lda, ldb; };

struct StaticOrder {
    int nM, nN, nwg, G, c;
    __device__ void init(int Mr, int N, int G_, int c_) { nM = Mr / BM; nN = N / BM; nwg = nM * nN; G = G_; c = c_; }
    __device__ bool next(int i, int& pm, int& pn) const {
        const long L = (long)i * G + c; if (L >= nwg) return false;
        int wgid = (int)L; { const int q = nwg / NXCD, r = nwg % NXCD, xcd = wgid % NXCD, off = wgid / NXCD; wgid = (xcd < r ? xcd * (q + 1) : r * (q + 1) + (xcd - r) * q) + off; }
        const int nig = WGM * nN, gid = wgid / nig, fm = gid * WGM, gsz = (nM - fm) < WGM ? (nM - fm) : WGM;
        pm = fm + ((wgid % nig) % gsz); pn = (wgid % nig) / gsz; return true;
    }
};

template <class Epi, class Sched>
__device__ __forceinline__ void gemm_phase(LAS unsigned char* lds, const Gemm g, const Sched& S, const Epi& E) {
    int tid_ = threadIdx.x; asm volatile("" : "+v"(tid_));
    const int tid = tid_, wid = __builtin_amdgcn_readfirstlane(tid >> 6), lane = tid & 63, wr = wid >> 2, wc = wid & 3, fr = lane & 15, fq = lane >> 4;
    const int K = g.K, nt = K / BK;
    unsigned voffA[2], voffB[2];
#pragma unroll
    for (int i = 0; i < 2; ++i) { int R, C; stage_rc(tid * 16 + i * 8192, R, C); const int Rb = Epi::PERM ? ((R & ~31) + perm32(R & 31)) : R;
        voffA[i] = (unsigned)(R * g.lda + C) * 2u; voffB[i] = (unsigned)(Rb * g.ldb + C) * 2u; }
    const size_t kstep = (size_t)(BK * 2);
    const size_t hstepA = (size_t)HALF * g.lda * 2, hstepB = (size_t)HALF * g.ldb * 2;
    const unsigned ldsw = (unsigned)wid * 1024u;
    const int aoff = lds_byte(wr * 64 + fr, fq * 8), boff = lds_byte(wc * 32 + fr, fq * 8);
#define PG8_SA(b, h) (((b) * 2 + (h)) * HTB)
#define PG8_SB(b, h) ((4 + (b) * 2 + (h)) * HTB)
#define PG8_STAGE(bufoff, gbase, voff) do { _Pragma("unroll") for (int _i = 0; _i < 2; ++_i) \
        __builtin_amdgcn_global_load_lds((const unsigned*)((const char*)(gbase) + (voff)[_i]), (LAS unsigned*)(lds + (bufoff) + ldsw + _i * 8192), 16, 0, 0); } while (0)
#define PG8_LDA(dst, b, h) do { _Pragma("unroll") for (int m = 0; m < 4; ++m) _Pragma("unroll") for (int k = 0; k < 2; ++k) dst[m][k] = *(const LAS bf16x8*)(lds + PG8_SA(b, h) + aoff + m * 2048 + k * 1024); } while (0)
#define PG8_LDB(dst, b, h) do { _Pragma("unroll") for (int n = 0; n < 2; ++n) _Pragma("unroll") for (int k = 0; k < 2; ++k) dst[n][k] = *(const LAS bf16x8*)(lds + PG8_SB(b, h) + boff + n * 2048 + k * 1024); } while (0)
#define PG8_MMA(ai, bj, At, Bt) do { __builtin_amdgcn_s_setprio(1); _Pragma("unroll") for (int m = 0; m < 4; ++m) _Pragma("unroll") for (int n = 0; n < 2; ++n) _Pragma("unroll") for (int k = 0; k < 2; ++k) \
        acc[ai][bj][m][n] = __builtin_amdgcn_mfma_f32_16x16x32_bf16(Bt[n][k], At[m][k], acc[ai][bj][m][n], 0, 0, 0); __builtin_amdgcn_s_setprio(0); } while (0)
#define PG8_WAIT_V(n) asm volatile("s_waitcnt vmcnt(" #n ")" ::: "memory")
#define PG8_WAIT_L(n) asm volatile("s_waitcnt lgkmcnt(" #n ")" ::: "memory")
#define PG8_BAR __builtin_amdgcn_s_barrier()
#define PG8_SCHED __builtin_amdgcn_sched_barrier(0)
    Unit cur, nxt; int ui = 0;
    if (!S.next(0, cur)) return;
    f32x4 acc[2][2][4][2];
#pragma unroll
    for (int a = 0; a < 2; ++a)
#pragma unroll
        for (int b = 0; b < 2; ++b)
#pragma unroll
            for (int m = 0; m < 4; ++m)
#pragma unroll
                for (int n = 0; n < 2; ++n) acc[a][b][m][n] = (f32x4){0.f, 0.f, 0.f, 0.f};
    bf16x8 At[4][2], B0[2][2], B1[2][2];
    const char* cA = g.A + cur.aoff; const char* cB = g.Bt + cur.boff;
    PG8_STAGE(PG8_SB(0, 0), cB, voffB); PG8_STAGE(PG8_SB(0, 1), cB + hstepB, voffB); PG8_STAGE(PG8_SA(0, 0), cA, voffA); PG8_STAGE(PG8_SA(0, 1), cA + hstepA, voffA);
    if (wr == 1) PG8_BAR;
    PG8_WAIT_V(2); PG8_BAR;
    PG8_STAGE(PG8_SB(1, 0), cB + kstep, voffB); PG8_STAGE(PG8_SA(1, 0), cA + kstep, voffA); PG8_STAGE(PG8_SB(1, 1), cB + hstepB + kstep, voffB);
    PG8_WAIT_V(6); PG8_BAR;
    for (;;) {
        const bool has_next = S.next(ui + 1, nxt);
        const char* nA = has_next ? g.A + nxt.aoff : cA; const char* nB = has_next ? g.Bt + nxt.boff : cB;
        for (int t = 0; t < nt; t += 2) {
            const bool last = (t == nt - 2);
            const char* a1 = cA + (size_t)(t + 1) * kstep;
            const char* a2 = last ? nA : cA + (size_t)(t + 2) * kstep; const char* b2 = last ? nB : cB + (size_t)(t + 2) * kstep;
            const char* a3 = a2 + kstep; const char* b3 = b2 + kstep;
            PG8_LDB(B0, 0, 0); PG8_LDB(B1, 0, 1); PG8_SCHED; PG8_LDA(At, 0, 0); PG8_STAGE(PG8_SA(1, 1), a1 + hstepA, voffA);
            PG8_WAIT_V(8); PG8_WAIT_L(0); PG8_BAR; PG8_MMA(0, 0, At, B0); PG8_MMA(0, 1, At, B1); PG8_BAR; PG8_SCHED;
            PG8_LDA(At, 0, 1); PG8_STAGE(PG8_SB(0, 0), b2, voffB); PG8_STAGE(PG8_SB(0, 1), b2 + hstepB, voffB); PG8_STAGE(PG8_SA(0, 0), a2, voffA);
            PG8_WAIT_V(8); PG8_WAIT_L(0); PG8_BAR; PG8_MMA(1, 0, At, B0); PG8_MMA(1, 1, At, B1); PG8_BAR; PG8_SCHED;
            PG8_LDB(B0, 1, 0); PG8_LDB(B1, 1, 1); PG8_SCHED; PG8_LDA(At, 1, 0); PG8_STAGE(PG8_SA(0, 1), a2 + hstepA, voffA);
            PG8_WAIT_V(8); PG8_WAIT_L(0); PG8_BAR; PG8_MMA(0, 0, At, B0); PG8_MMA(0, 1, At, B1); PG8_BAR; PG8_SCHED;
            PG8_LDA(At, 1, 1); PG8_STAGE(PG8_SB(1, 0), b3, voffB); PG8_STAGE(PG8_SB(1, 1), b3 + hstepB, voffB); PG8_STAGE(PG8_SA(1, 0), a3, voffA);
            PG8_WAIT_V(8); PG8_WAIT_L(0); PG8_BAR; PG8_MMA(1, 0, At, B0); PG8_MMA(1, 1, At, B1); PG8_BAR; PG8_SCHED;
        }
        if (wr == 0) PG8_BAR;
        int le = lane; asm volatile("" : "+v"(le));
        const bool keep = E(acc, cur, wr, wc, le & 15, le >> 4);
        if (!has_next) break;
        if (!keep) {
#pragma unroll
            for (int a = 0; a < 2; ++a)
#pragma unroll
                for (int b = 0; b < 2; ++b)
#pragma unroll
                    for (int m = 0; m < 4; ++m)
#pragma unroll
                        for (int n = 0; n < 2; ++n) acc[a][b][m][n] = (f32x4){0.f, 0.f, 0.f, 0.f};
        }
        cur = nxt; cA = nA; cB = nB; ++ui;
        if (wr == 1) PG8_BAR;
    }
    PG8_WAIT_V(0);
    PG8_BAR;
#undef PG8_SA
#undef PG8_SB
#undef PG8_STAGE
#undef PG8_LDA
#undef PG8_LDB
#undef PG8_MMA
#undef PG8_WAIT_V
#undef PG8_WAIT_L
#undef PG8_BAR
#undef PG8_SCHED
}
}
using pg8::Unit; using pg8::Gemm; using pg8::StaticOrder;

struct SchedPlain {
    StaticOrder so; long astep, bstep;
    __device__ bool next(int i, Unit& u) const { if (!so.next(i, u.pm, u.pn)) return false; u.tag = 0; u.aoff = (long)u.pm * astep; u.boff = (long)u.pn * bstep; return true; }
};
struct SchedGroup {
    int G, c; long astep, bstep;
    __device__ bool next(int i, Unit& u) const { const int L = i * G + c; if (L >= 256) return false; u.pm = L; u.pn = 0; u.tag = 0; u.aoff = (long)L * astep; u.boff = (long)(L >> 3) * bstep; return true; }
};
struct SchedPair {
    StaticOrder so; long astep, bstep, a1off, b1off;
    __device__ bool next(int i, Unit& u) const { if (!so.next(i >> 1, u.pm, u.pn)) return false; u.tag = i & 1; u.aoff = (long)u.pm * astep + (u.tag ? a1off : 0); u.boff = (long)u.pn * bstep + (u.tag ? b1off : 0); return true; }
};

struct EpiInProj {
    static constexpr bool PERM = true;
    bf16 *Q, *Kb, *VT, *UA, *GA, *GS; const f32x2* rope;
    __device__ __forceinline__ bool operator()(f32x4 (&acc)[2][2][4][2], const Unit& u, int wr, int wc, int fr, int fq) const {
        const int pn = u.pn;
#pragma unroll
        for (int ai = 0; ai < 2; ++ai)
#pragma unroll
            for (int m = 0; m < 4; ++m) {
                const int r = u.pm * 256 + ai * 128 + wr * 64 + m * 16 + fr; const int t = r & (SEQ - 1), b = r >> 13;
#pragma unroll
                for (int bj = 0; bj < 2; ++bj) {
                    float v[8]; { const f32x4 v0 = acc[ai][bj][m][0], v1 = acc[ai][bj][m][1]; v[0] = v0[0]; v[1] = v0[1]; v[2] = v0[2]; v[3] = v0[3]; v[4] = v1[0]; v[5] = v1[1]; v[6] = v1[2]; v[7] = v1[3]; }
                    const int cl = (pn & 1) * 256 + bj * 128 + wc * 32 + 8 * fq;
                    if (pn < 4) {
                        if ((wc & 1) == 0) {
                            float o[8];
#pragma unroll
                            for (int e = 0; e < 8; ++e) o[e] = __shfl_xor(v[e], 16);
                            if (fq < 2) {
                                const f32x4* rp = (const f32x4*)(rope + (size_t)t * 8);
#pragma unroll
                                for (int e2 = 0; e2 < 4; ++e2) { const f32x4 cs = rp[e2];
                                    const int e = 2 * e2;
                                    if (fq == 0) { v[e] = v[e] * cs[0] - o[e] * cs[1]; v[e + 1] = v[e + 1] * cs[2] - o[e + 1] * cs[3]; }
                                    else         { v[e] = o[e] * cs[1] + v[e] * cs[0]; v[e + 1] = o[e + 1] * cs[3] + v[e + 1] * cs[2]; } }
                            }
                        }
                        bf16* dst = (pn < 2 ? Q : Kb) + (size_t)r * AW + cl;
                        *(u32x4*)dst = pack8(v);
                    } else if (pn < 6) {
                        const int h = cl >> 6, d = cl & 63;
                        bf16* dst = VT + ((size_t)(b * NH + h) * HD + d) * SEQ + t;
#pragma unroll
                        for (int e = 0; e < 8; ++e) dst[(size_t)e * SEQ] = f2bf(v[e]);
                    } else if (pn < 8) {
                        const int gidx = cl >> 4, hi0 = cl & 15;
                        bf16* dst = UA + ((size_t)(gidx * NB + b) * NCH + (t >> 4)) * UROW + (t & 15) * 16 + hi0;
                        *(u32x4*)dst = pack8(v);
                    } else {
                        const int gc = ((pn - 8) & 3) * 256 + bj * 128 + wc * 32 + 8 * fq;
#pragma unroll
                        for (int e = 0; e < 8; ++e) v[e] = fsigmoid(v[e]);
                        bf16* dst = (pn < 12 ? GA : GS) + (size_t)r * D + gc;
                        *(u32x4*)dst = pack8(v);
                    }
                }
            }
        return false;
    }
};
struct EpiE {
    static constexpr bool PERM = false;
    float* E;
    __device__ __forceinline__ bool operator()(f32x4 (&acc)[2][2][4][2], const Unit& u, int wr, int wc, int fr, int fq) const {
#pragma unroll
        for (int ai = 0; ai < 2; ++ai)
#pragma unroll
            for (int m = 0; m < 4; ++m) { const int r = u.pm * 256 + ai * 128 + wr * 64 + m * 16 + fr;
#pragma unroll
                for (int n = 0; n < 2; ++n) *(f32x4*)(E + (size_t)r * 128 + wc * 32 + n * 16 + 4 * fq) = acc[ai][0][m][n]; }
        return false;
    }
};
struct EpiY {
    static constexpr bool PERM = false;
    const bf16* UA; const float* dskip; bf16* Y;
    __device__ __forceinline__ bool operator()(f32x4 (&acc)[2][2][4][2], const Unit& u, int wr, int wc, int fr, int fq) const {
        const int g = u.pm >> 3;
        const f32x4 dv = *(const f32x4*)(dskip + g * 16 + 4 * fq);
#pragma unroll
        for (int ai = 0; ai < 2; ++ai)
#pragma unroll
            for (int m = 0; m < 4; ++m) { const int r = u.pm * 256 + ai * 128 + wr * 64 + m * 16 + fr; const int b = (r >> 9) & 3, c = r & 511;
#pragma unroll
                for (int bj = 0; bj < 2; ++bj)
#pragma unroll
                    for (int n = 0; n < 2; ++n) { const int i = 8 * bj + 2 * wc + n;
                        const u32x2 uw = *(const u32x2*)(UA + (size_t)r * UROW + i * 16 + 4 * fq);
                        const f32x4 a = acc[ai][bj][m][n];
                        const float y0 = gelu_tanh(a[0] + dv[0] * bflo(uw.x)), y1 = gelu_tanh(a[1] + dv[1] * bfhi(uw.x)), y2 = gelu_tanh(a[2] + dv[2] * bflo(uw.y)), y3 = gelu_tanh(a[3] + dv[3] * bfhi(uw.y));
                        u32x2 w; w.x = cvtpk(y0, y1); w.y = cvtpk(y2, y3);
                        *(u32x2*)(Y + ((size_t)b * SEQ + c * 16 + i) * SW + g * 16 + 4 * fq) = w; } }
        return false;
    }
};
struct EpiGLU {
    static constexpr bool PERM = true;
    const bf16* Y; bf16* O;
    __device__ __forceinline__ bool operator()(f32x4 (&acc)[2][2][4][2], const Unit& u, int wr, int wc, int fr, int fq) const {
#pragma unroll
        for (int ai = 0; ai < 2; ++ai)
#pragma unroll
            for (int m = 0; m < 4; ++m) { const int r = u.pm * 256 + ai * 128 + wr * 64 + m * 16 + fr;
#pragma unroll
                for (int bj = 0; bj < 2; ++bj) { const int c = u.pn * 256 + bj * 128 + wc * 32 + 8 * fq;
                    float y[8]; unpack8(*(const u32x4*)(Y + (size_t)r * SW + c), y);
                    const f32x4 v0 = acc[ai][bj][m][0], v1 = acc[ai][bj][m][1];
                    float o[8]; o[0] = y[0] * fsigmoid(v0[0]); o[1] = y[1] * fsigmoid(v0[1]); o[2] = y[2] * fsigmoid(v0[2]); o[3] = y[3] * fsigmoid(v0[3]);
                    o[4] = y[4] * fsigmoid(v1[0]); o[5] = y[5] * fsigmoid(v1[1]); o[6] = y[6] * fsigmoid(v1[2]); o[7] = y[7] * fsigmoid(v1[3]);
                    *(u32x4*)(O + (size_t)r * SW + c) = pack8(o); } }
        return false;
    }
};
struct EpiMerge {
    static constexpr bool PERM = true;
    const bf16 *GA, *GS; bf16* O;
    __device__ __forceinline__ bool operator()(f32x4 (&acc)[2][2][4][2], const Unit& u, int wr, int wc, int fr, int fq) const {
        const bool first = (u.tag == 0);
#pragma unroll
        for (int ai = 0; ai < 2; ++ai)
#pragma unroll
            for (int m = 0; m < 4; ++m) { const int r = u.pm * 256 + ai * 128 + wr * 64 + m * 16 + fr;
#pragma unroll
                for (int bj = 0; bj < 2; ++bj) { const int c = u.pn * 256 + bj * 128 + wc * 32 + 8 * fq;
                    float gs[8]; unpack8(*(const u32x4*)(GS + (size_t)r * D + c), gs);
                    if (first) { float ga[8]; unpack8(*(const u32x4*)(GA + (size_t)r * D + c), ga);
#pragma unroll
                        for (int e = 0; e < 4; ++e) { acc[ai][bj][m][0][e] *= ga[e] / gs[e]; acc[ai][bj][m][1][e] *= ga[4 + e] / gs[4 + e]; } }
                    else { float o[8];
#pragma unroll
                        for (int e = 0; e < 4; ++e) { o[e] = acc[ai][bj][m][0][e] * gs[e]; o[4 + e] = acc[ai][bj][m][1][e] * gs[4 + e]; }
                        *(u32x4*)(O + (size_t)r * D + c) = pack8(o); } } }
        return first;
    }
};
struct EpiBf16 {
    static constexpr bool PERM = true;
    bf16* O; int ldc;
    __device__ __forceinline__ bool operator()(f32x4 (&acc)[2][2][4][2], const Unit& u, int wr, int wc, int fr, int fq) const {
#pragma unroll
        for (int ai = 0; ai < 2; ++ai)
#pragma unroll
            for (int m = 0; m < 4; ++m) { const int r = u.pm * 256 + ai * 128 + wr * 64 + m * 16 + fr;
#pragma unroll
                for (int bj = 0; bj < 2; ++bj) { const int c = u.pn * 256 + bj * 128 + wc * 32 + 8 * fq;
                    const f32x4 v0 = acc[ai][bj][m][0], v1 = acc[ai][bj][m][1];
                    u32x4 w; w.x = cvtpk(v0[0], v0[1]); w.y = cvtpk(v0[2], v0[3]); w.z = cvtpk(v1[0], v1[1]); w.w = cvtpk(v1[2], v1[3]);
                    *(u32x4*)(O + (size_t)r * ldc + c) = w; } }
        return false;
    }
};
struct EpiLN {
    static constexpr bool PERM = false;
    const float* base; float* outf; bf16* outb; const float* gam; const float* bet; unsigned* cnt; LAS unsigned* flag; int row0;
    __device__ __forceinline__ bool operator()(f32x4 (&acc)[2][2][4][2], const Unit& u, int wr, int wc, int fr, int fq) const {
        const int col0 = u.pn * 256 + wc * 32 + 4 * fq;
#pragma unroll
        for (int ai = 0; ai < 2; ++ai)
#pragma unroll
            for (int m = 0; m < 4; ++m) { const size_t r = (size_t)row0 + u.pm * 256 + ai * 128 + wr * 64 + m * 16 + fr;
#pragma unroll
                for (int bj = 0; bj < 2; ++bj)
#pragma unroll
                    for (int n = 0; n < 2; ++n) { const size_t off = r * D + col0 + bj * 128 + n * 16;
                        const f32x4 bs = *(const f32x4*)(base + off); *(f32x4*)(outf + off) = bs * ALPHA + acc[ai][bj][m][n]; } }
        asm volatile("s_waitcnt vmcnt(0)" ::: "memory");
        __syncthreads();
        if (threadIdx.x == 0) {
            __threadfence();
            const unsigned old = __hip_atomic_fetch_add(cnt + 64 * ((row0 >> 8) + u.pm), 1u, __ATOMIC_RELAXED, __HIP_MEMORY_SCOPE_AGENT);
            if (old == 3u) __threadfence();
            flag[0] = (old == 3u) ? 1u : 0u;
        }
        __syncthreads();
        if (flag[0] != 0u) {
            const int lane = threadIdx.x & 63, wave = threadIdx.x >> 6;
            const f32x4 g0 = *(const f32x4*)(gam + 4 * lane), g1 = *(const f32x4*)(gam + 256 + 4 * lane), g2 = *(const f32x4*)(gam + 512 + 4 * lane), g3 = *(const f32x4*)(gam + 768 + 4 * lane);
            const f32x4 b0 = *(const f32x4*)(bet + 4 * lane), b1 = *(const f32x4*)(bet + 256 + 4 * lane), b2 = *(const f32x4*)(bet + 512 + 4 * lane), b3 = *(const f32x4*)(bet + 768 + 4 * lane);
            for (int i = 0; i < 32; ++i) {
                const size_t r = (size_t)row0 + u.pm * 256 + wave * 32 + i;
                float* rowp = outf + r * D + 4 * lane;
                f32x4 v0 = *(const f32x4*)(rowp), v1 = *(const f32x4*)(rowp + 256), v2 = *(const f32x4*)(rowp + 512), v3 = *(const f32x4*)(rowp + 768);
                float s = (v0[0] + v0[1] + v0[2] + v0[3]) + (v1[0] + v1[1] + v1[2] + v1[3]) + (v2[0] + v2[1] + v2[2] + v2[3]) + (v3[0] + v3[1] + v3[2] + v3[3]);
#pragma unroll
                for (int o = 1; o < 64; o <<= 1) s += __shfl_xor(s, o);
                const float mean = s * (1.0f / D);
                v0 = v0 - mean; v1 = v1 - mean; v2 = v2 - mean; v3 = v3 - mean;
                float q = (v0[0] * v0[0] + v0[1] * v0[1] + v0[2] * v0[2] + v0[3] * v0[3]) + (v1[0] * v1[0] + v1[1] * v1[1] + v1[2] * v1[2] + v1[3] * v1[3])
                        + (v2[0] * v2[0] + v2[1] * v2[1] + v2[2] * v2[2] + v2[3] * v2[3]) + (v3[0] * v3[0] + v3[1] * v3[1] + v3[2] * v3[2] + v3[3] * v3[3]);
#pragma unroll
                for (int o = 1; o < 64; o <<= 1) q += __shfl_xor(q, o);
                const float rstd = 1.0f / sqrtf(q * (1.0f / D) + LN_EPS);
                v0 = v0 * rstd * g0 + b0; v1 = v1 * rstd * g1 + b1; v2 = v2 * rstd * g2 + b2; v3 = v3 * rstd * g3 + b3;
                *(f32x4*)(rowp) = v0; *(f32x4*)(rowp + 256) = v1; *(f32x4*)(rowp + 512) = v2; *(f32x4*)(rowp + 768) = v3;
                if (outb) { bf16* bp = outb + r * D + 4 * lane;
                    u32x2 w; w.x = cvtpk(v0[0], v0[1]); w.y = cvtpk(v0[2], v0[3]); *(u32x2*)(bp) = w;
                    w.x = cvtpk(v1[0], v1[1]); w.y = cvtpk(v1[2], v1[3]); *(u32x2*)(bp + 256) = w;
                    w.x = cvtpk(v2[0], v2[1]); w.y = cvtpk(v2[2], v2[3]); *(u32x2*)(bp + 512) = w;
                    w.x = cvtpk(v3[0], v3[1]); w.y = cvtpk(v3[2], v3[3]); *(u32x2*)(bp + 768) = w; }
            }
        }
        return false;
    }
};

struct Args { const float* in[22]; float* out; unsigned char* ws; };
struct Frame { int tid, lane, wave, G, bid; LAS unsigned char* lds; };
typedef const __attribute__((address_space(4))) Args* KArgs;
__device__ __forceinline__ KArgs kargs() { KArgs p = (KArgs)__builtin_amdgcn_kernarg_segment_ptr(); asm volatile("" : "+s"(p)); return p; }
__device__ __forceinline__ Frame make_frame() {
    extern __shared__ __attribute__((aligned(16))) unsigned char lds_raw[];
    Frame F; int t = threadIdx.x; asm volatile("" : "+v"(t)); F.tid = t; F.lane = t & 63; F.wave = __builtin_amdgcn_readfirstlane(t >> 6);
    int g = gridDim.x, b = blockIdx.x; asm volatile("" : "+s"(g), "+s"(b)); F.G = g; F.bid = b; F.lds = (LAS unsigned char*)lds_raw; return F;
}

__device__ __forceinline__ void transpose_item(const float* W, int K, int N, bf16* WT, LAS float* scr, int item, int lane) {
    const int nblk = N / 32, kb = item / nblk, nb = item % nblk, k0 = 64 * kb, n0 = 32 * nb;
#pragma unroll 8
    for (int i = 0; i < 32; ++i) { const int kk = 2 * i + (lane >> 5); scr[kk * 33 + (lane & 31)] = W[(size_t)(k0 + kk) * N + n0 + (lane & 31)]; }
    asm volatile("s_waitcnt lgkmcnt(0)" ::: "memory");
    const int c = lane & 7;
#pragma unroll
    for (int j = 0; j < 4; ++j) { const int n = (lane >> 3) + 8 * j; const LAS float* s = scr + (8 * c) * 33 + n;
        u32x4 o; o.x = cvtpk(s[0 * 33], s[1 * 33]); o.y = cvtpk(s[2 * 33], s[3 * 33]); o.z = cvtpk(s[4 * 33], s[5 * 33]); o.w = cvtpk(s[6 * 33], s[7 * 33]);
        *(u32x4*)(WT + (size_t)(n0 + n) * K + k0 + 8 * c) = o; }
    asm volatile("s_waitcnt lgkmcnt(0)" ::: "memory");
}

__device__ __forceinline__ void p0_prologue() {
    const Frame F = make_frame(); const KArgs a = kargs();
    unsigned char* ws = a->ws;
    LAS float* scr = (LAS float*)(F.lds + F.wave * 16384);
    const int gw = F.bid * 8 + F.wave, NGW = F.G * 8;
    constexpr int I0 = (D / 64) * (INW / 32), I1 = (AW / 64) * (D / 32), I2 = (SW / 64) * (SW / 32), I3 = (SW / 64) * (D / 32), I4 = (D / 64) * (D / 32), I5 = (D / 64) * (FF2 / 32), I6 = (FF / 64) * (D / 32);
    constexpr int NIT = I0 + I1 + I2 + I3 + I4 + I5 + I6;
    for (int it = gw; it < NIT; it += NGW) {
        int r = it;
        if (r < I0) { transpose_item(a->in[1], D, INW, (bf16*)(ws + WS_WIN), scr, r, F.lane); continue; } r -= I0;
        if (r < I1) { transpose_item(a->in[2], AW, D, (bf16*)(ws + WS_WAP), scr, r, F.lane); continue; } r -= I1;
        if (r < I2) { transpose_item(a->in[11], SW, SW, (bf16*)(ws + WS_WGLU), scr, r, F.lane); continue; } r -= I2;
        if (r < I3) { transpose_item(a->in[12], SW, D, (bf16*)(ws + WS_WSP), scr, r, F.lane); continue; } r -= I3;
        if (r < I4) { transpose_item(a->in[13], D, D, (bf16*)(ws + WS_WOUT), scr, r, F.lane); continue; } r -= I4;
        if (r < I5) { transpose_item(a->in[16], D, FF2, (bf16*)(ws + WS_WUP), scr, r, F.lane); continue; } r -= I5;
        transpose_item(a->in[19], FF, D, (bf16*)(ws + WS_WDN), scr, r, F.lane);
    }
    const int gt = F.bid * 512 + F.tid, NGT = F.G * 512;
    { const f32x4* x4 = (const f32x4*)a->in[0]; u32x4* xb = (u32x4*)(ws + WS_XB);
      for (int i = gt; i < M * D / 8; i += NGT) { const f32x4 p = x4[2 * (size_t)i], q = x4[2 * (size_t)i + 1]; u32x4 w; w.x = cvtpk(p[0], p[1]); w.y = cvtpk(p[2], p[3]); w.z = cvtpk(q[0], q[1]); w.w = cvtpk(q[2], q[3]); xb[i] = w; } }
    { f32x2* rope = (f32x2*)(ws + WS_ROPE);
      for (int i = gt; i < SEQ * 8; i += NGT) { const int t = i >> 3, j = i & 7;
          const float invf = (float)exp(-(double)j * 0.125 * 13.122363377404328);
          const float ang = (float)t * invf; double s, c; dsincos((double)ang, s, c);
          rope[i] = (f32x2){(float)c, (float)s}; } }
    { f32x2* lbpow = (f32x2*)(ws + WS_LBPOW); f32x2* zb = (f32x2*)(ws + WS_ZB);
      for (int i = gt; i < NG * NP; i += NGT) { const int g = i >> 6;
          const double are = (double)a->in[3][i], aim = (double)a->in[4][i], dt = exp((double)a->in[5][g]);
          const double mag = exp(are * dt); double sn, cs; dsincos(aim * dt, sn, cs);
          const double lr = mag * cs, li = mag * sn;
          const double den = are * are + aim * aim, nre = lr - 1.0, nim = li;
          const double zr = (nre * are + nim * aim) / den, zi = (nim * are - nre * aim) / den;
          double pr = 1.0, pi = 0.0;
          for (int tau = 0; tau <= 16; ++tau) { lbpow[i * 17 + tau] = (f32x2){(float)pr, (float)pi}; const double nr = pr * lr - pi * li, ni = pr * li + pi * lr; pr = nr; pi = ni; }
          for (int hi = 0; hi < 16; ++hi) { const double br = (double)a->in[6][i * 16 + hi], bi = (double)a->in[7][i * 16 + hi]; zb[i * 16 + hi] = (f32x2){(float)(zr * br - zi * bi), (float)(zr * bi + zi * br)}; } } }
}

__device__ __forceinline__ void ssm_weights() {
    const Frame F = make_frame(); const KArgs a = kargs();
    unsigned char* ws = a->ws;
    const f32x2* lbpow = (const f32x2*)(ws + WS_LBPOW); const f32x2* zb = (const f32x2*)(ws + WS_ZB);
    bf16* WE = (bf16*)(ws + WS_WE); bf16* WY = (bf16*)(ws + WS_WY);
    const float* cre = a->in[8]; const float* cim = a->in[9];
    const int gt = F.bid * 512 + F.tid, NGT = F.G * 512;
    for (int i = gt; i < NG * 16 * 256; i += NGT) { const int hi = i & 15, ho = (i >> 4) & 15, tau = (i >> 8) & 15, g = i >> 12;
        float s = 0.f;
        for (int p = 0; p < NP; ++p) { const int gp = g * 64 + p; const float cr = cre[(g * 16 + ho) * 64 + p], ci = cim[(g * 16 + ho) * 64 + p];
            const f32x2 l = lbpow[gp * 17 + tau], z = zb[gp * 16 + hi];
            const float ar = cr * l.x - ci * l.y, ai = cr * l.y + ci * l.x; s += ar * z.x - ai * z.y; }
        const bf16 sv = f2bf(s);
        bf16* base = WY + (size_t)g * 256 * UROW;
        for (int j = 0; j + tau < 16; ++j) { const int ii = j + tau; base[(size_t)(ii * 16 + ho) * UROW + j * 16 + hi] = sv; if (tau > 0) base[(size_t)(j * 16 + ho) * UROW + ii * 16 + hi] = 0; } }
    for (int i = gt; i < NG * 256 * 64; i += NGT) { const int p = i & 63, n = (i >> 6) & 255, g = i >> 14; const int ii = n >> 4, ho = n & 15;
        const float cr = cre[(g * 16 + ho) * 64 + p], ci = cim[(g * 16 + ho) * 64 + p]; const f32x2 l = lbpow[(g * 64 + p) * 17 + ii + 1];
        bf16* row = WY + ((size_t)g * 256 + n) * UROW;
        row[256 + p] = f2bf(cr * l.x - ci * l.y); row[320 + p] = f2bf(-(cr * l.y + ci * l.x)); }
    for (int i = gt; i < NG * 64 * 256; i += NGT) { const int k = i & 255, p = (i >> 8) & 63, g = i >> 14; const int j = k >> 4, hi = k & 15;
        const f32x2 l = lbpow[(g * 64 + p) * 17 + 15 - j], z = zb[(g * 64 + p) * 16 + hi];
        bf16* base = WE + (size_t)g * 256 * 256;
        base[(size_t)p * 256 + k] = f2bf(l.x * z.x - l.y * z.y); base[(size_t)(64 + p) * 256 + k] = f2bf(l.x * z.y + l.y * z.x); }
    for (int i = gt; i < NG * 128 * 256 / 8; i += NGT) { const int g = i >> 12, rem = i & 4095; *(u32x4*)(WE + (size_t)g * 65536 + 32768 + rem * 8) = (u32x4){0u, 0u, 0u, 0u}; }
}

__device__ __forceinline__ void kmean_phase() {
    const Frame F = make_frame(); const KArgs a = kargs();
    const bf16* Kb = (const bf16*)(a->ws + WS_K); float* km = (float*)(a->ws + WS_KMEAN);
    for (int it = F.bid * 8 + F.wave; it < 32 * NBLK; it += F.G * 8) { const int bh = it >> 5, n = it & 31, b = bh >> 3, h = bh & 7;
        float s[8] = {0.f, 0.f, 0.f, 0.f, 0.f, 0.f, 0.f, 0.f};
        const bf16* p = Kb + ((size_t)b * SEQ + n * 256 + (F.lane >> 3)) * AW + h * 64 + 8 * (F.lane & 7);
#pragma unroll 4
        for (int i = 0; i < 32; ++i) { float f[8]; unpack8(*(const u32x4*)(p + (size_t)i * 8 * AW), f);
#pragma unroll
            for (int e = 0; e < 8; ++e) s[e] += f[e]; }
#pragma unroll
        for (int e = 0; e < 8; ++e) { s[e] += __shfl_xor(s[e], 8); s[e] += __shfl_xor(s[e], 16); s[e] += __shfl_xor(s[e], 32); }
        if (F.lane < 8) { float* o = km + (size_t)it * 64 + 8 * F.lane;
#pragma unroll
            for (int e = 0; e < 8; ++e) o[e] = s[e] * (1.0f / 256.0f); }
    }
}
__device__ __forceinline__ void select_phase() {
    const Frame F = make_frame(); const KArgs a = kargs();
    const bf16* Q = (const bf16*)(a->ws + WS_Q); const float* km = (const float*)(a->ws + WS_KMEAN); unsigned* sel = (unsigned*)(a->ws + WS_SEL);
    for (int it = F.bid; it < 32 * 16; it += F.G) { const int bh = it >> 4, b = bh >> 3, h = bh & 7, t = (it & 15) * 512 + F.tid, own = t >> 8;
        float q[64];
        const bf16* qp = Q + ((size_t)b * SEQ + t) * AW + h * 64;
#pragma unroll
        for (int c = 0; c < 8; ++c) unpack8(*(const u32x4*)(qp + 8 * c), q + 8 * c);
        float v1 = -3.0e38f, v2 = -3.0e38f, v3 = -3.0e38f; int i1 = -1, i2 = -1, i3 = -1;
        for (int n = 0; n < own; ++n) { const f32x4* kp = (const f32x4*)(km + ((size_t)bh * 32 + n) * 64);
            float d0 = 0.f, d1 = 0.f, d2 = 0.f, d3 = 0.f;
#pragma unroll
            for (int c = 0; c < 16; ++c) { const f32x4 kv = kp[c]; d0 += q[4 * c] * kv[0]; d1 += q[4 * c + 1] * kv[1]; d2 += q[4 * c + 2] * kv[2]; d3 += q[4 * c + 3] * kv[3]; }
            const float dd = (d0 + d1) + (d2 + d3);
            if (dd > v1) { v3 = v2; i3 = i2; v2 = v1; i2 = i1; v1 = dd; i1 = n; }
            else if (dd > v2) { v3 = v2; i3 = i2; v2 = dd; i2 = n; }
            else if (dd > v3) { v3 = dd; i3 = n; } }
        unsigned mask = 0u; if (i1 >= 0) mask |= 1u << i1; if (i2 >= 0) mask |= 1u << i2; if (i3 >= 0) mask |= 1u << i3;
        sel[(size_t)bh * SEQ + t] = mask; }
}
__device__ __forceinline__ void scan_phase() {
    const Frame F = make_frame(); const KArgs a = kargs();
    if (F.bid >= NG * NB) return;
    const int g = F.bid >> 2, b = F.bid & 3, p = F.tid & 63, seg = F.tid >> 6;
    const float* E = (const float*)(a->ws + WS_E) + ((size_t)(g * NB + b) * NCH + seg * 64) * 128;
    bf16* U = (bf16*)(a->ws + WS_UA) + ((size_t)(g * NB + b) * NCH + seg * 64) * UROW;
    const f32x2 L = ((const f32x2*)(a->ws + WS_LBPOW))[(g * 64 + p) * 17 + 16];
    LAS f32x2* ends = (LAS f32x2*)(F.lds);
    float hr = 0.f, hi = 0.f;
#pragma unroll 8
    for (int c = 0; c < 64; ++c) { const float er = E[c * 128 + p], ei = E[c * 128 + 64 + p]; const float nr = L.x * hr - L.y * hi + er, ni = L.x * hi + L.y * hr + ei; hr = nr; hi = ni; }
    ends[seg * 64 + p] = (f32x2){hr, hi};
    __syncthreads();
    float pr = L.x, pi = L.y;
#pragma unroll
    for (int s = 0; s < 6; ++s) { const float nr = pr * pr - pi * pi, ni = 2.f * pr * pi; pr = nr; pi = ni; }
    float cr = 0.f, ci = 0.f;
    for (int s = 0; s < seg; ++s) { const f32x2 e = ends[s * 64 + p]; const float nr = pr * cr - pi * ci + e.x, ni = pr * ci + pi * cr + e.y; cr = nr; ci = ni; }
    hr = cr; hi = ci;
#pragma unroll 8
    for (int c = 0; c < 64; ++c) { U[(size_t)c * UROW + 256 + p] = f2bf(hr); U[(size_t)c * UROW + 320 + p] = f2bf(hi);
        const float er = E[c * 128 + p], ei = E[c * 128 + 64 + p]; const float nr = L.x * hr - L.y * hi + er, ni = L.x * hi + L.y * hr + ei; hr = nr; hi = ni; }
    __syncthreads();
}

__device__ __forceinline__ void attn_tile(const bf16* Q, LAS const unsigned char* Ks, LAS const unsigned char* Vs, int h, size_t qrow, bool valid, int nkt, int diag, int qi,
                                          bf16* P, float* LSE, int slot, int lane) {
    const int r32 = lane & 31, hi = lane >> 5;
    bf16x8 qf[4];
#pragma unroll
    for (int d0 = 0; d0 < 4; ++d0) qf[d0] = *(const bf16x8*)(Q + qrow * AW + h * 64 + d0 * 16 + hi * 8);
    const int rr = (r32 & 3) + 4 * (r32 >> 3); const int prow = 16 * (rr >> 3) + 8 * ((r32 >> 2) & 1) + (rr & 7);
    f32x16 o0, o1;
#pragma unroll
    for (int i = 0; i < 16; ++i) { o0[i] = 0.f; o1[i] = 0.f; }
    float mrun = -1.0e30f, lrun = 0.f;
    const float C = 0.125f * 1.4426950408889634f;
    for (int kt = 0; kt < nkt; ++kt) {
        f32x16 s;
#pragma unroll
        for (int i = 0; i < 16; ++i) s[i] = 0.f;
        const LAS unsigned char* kb = Ks + (32 * kt + prow) * KS_STRIDE + hi * 16;
#pragma unroll
        for (int d0 = 0; d0 < 4; ++d0) { const bf16x8 kf = *(const LAS bf16x8*)(kb + d0 * 32); s = __builtin_amdgcn_mfma_f32_32x32x16_bf16(kf, qf[d0], s, 0, 0, 0); }
        if (kt == diag) {
#pragma unroll
            for (int r = 0; r < 16; ++r) { const int key = 32 * kt + 16 * (r >> 3) + 8 * hi + (r & 7); if (key > qi) s[r] = -1.0e30f; }
        }
        float mx = s[0];
#pragma unroll
        for (int r = 1; r < 16; ++r) mx = fmaxf(mx, s[r]);
        mx = fmaxf(mx, __shfl_xor(mx, 32));
        const float mnew = fmaxf(mrun, mx * C);
        const float alpha = __builtin_amdgcn_exp2f(mrun - mnew);
        float psum = 0.f;
#pragma unroll
        for (int r = 0; r < 16; ++r) { const float p = __builtin_amdgcn_exp2f(s[r] * C - mnew); s[r] = p; psum += p; }
        lrun = lrun * alpha + psum; mrun = mnew;
#pragma unroll
        for (int i = 0; i < 16; ++i) { o0[i] *= alpha; o1[i] *= alpha; }
        u32x4 w0, w1;
        w0.x = cvtpk(s[0], s[1]); w0.y = cvtpk(s[2], s[3]); w0.z = cvtpk(s[4], s[5]); w0.w = cvtpk(s[6], s[7]);
        w1.x = cvtpk(s[8], s[9]); w1.y = cvtpk(s[10], s[11]); w1.z = cvtpk(s[12], s[13]); w1.w = cvtpk(s[14], s[15]);
        const bf16x8 pb0 = __builtin_bit_cast(bf16x8, w0), pb1 = __builtin_bit_cast(bf16x8, w1);
        const LAS unsigned char* vb = Vs + r32 * VS_STRIDE + (32 * kt + 8 * hi) * 2;
        { const bf16x8 v00 = *(const LAS bf16x8*)(vb), v01 = *(const LAS bf16x8*)(vb + 32), v10 = *(const LAS bf16x8*)(vb + 32 * VS_STRIDE), v11 = *(const LAS bf16x8*)(vb + 32 * VS_STRIDE + 32);
          o0 = __builtin_amdgcn_mfma_f32_32x32x16_bf16(v00, pb0, o0, 0, 0, 0); o0 = __builtin_amdgcn_mfma_f32_32x32x16_bf16(v01, pb1, o0, 0, 0, 0);
          o1 = __builtin_amdgcn_mfma_f32_32x32x16_bf16(v10, pb0, o1, 0, 0, 0); o1 = __builtin_amdgcn_mfma_f32_32x32x16_bf16(v11, pb1, o1, 0, 0, 0); }
    }
    const float ltot = lrun + __shfl_xor(lrun, 32);
    if (valid) {
        const float inv = 1.0f / ltot;
        const size_t pi = (qrow * NH + h) * 4 + slot;
        bf16* dst = P + pi * 64 + 4 * hi;
#pragma unroll
        for (int g4 = 0; g4 < 4; ++g4) {
            u32x2 w; w.x = cvtpk(o0[4 * g4] * inv, o0[4 * g4 + 1] * inv); w.y = cvtpk(o0[4 * g4 + 2] * inv, o0[4 * g4 + 3] * inv); *(u32x2*)(dst + 8 * g4) = w;
            w.x = cvtpk(o1[4 * g4] * inv, o1[4 * g4 + 1] * inv); w.y = cvtpk(o1[4 * g4 + 2] * inv, o1[4 * g4 + 3] * inv); *(u32x2*)(dst + 32 + 8 * g4) = w; }
        if (hi == 0) LSE[pi] = mrun + __builtin_amdgcn_logf(ltot);
    }
}
__device__ __forceinline__ void attn_phase() {
    const Frame F = make_frame(); const KArgs a = kargs();
    unsigned char* ws = a->ws;
    const bf16* Q = (const bf16*)(ws + WS_Q); const bf16* Kb = (const bf16*)(ws + WS_K); const bf16* VT = (const bf16*)(ws + WS_VT);
    const unsigned* sel = (const unsigned*)(ws + WS_SEL); bf16* P = (bf16*)(ws + WS_PBUF); float* LSE = (float*)(ws + WS_LSE);
    unsigned* qctr = (unsigned*)(ws + WS_CTL) + CW_ATTQ;
    LAS unsigned char* Ks = F.lds + LDS_KS; LAS unsigned char* Vs = F.lds + LDS_VS;
    volatile LAS int* lst = (volatile LAS int*)(F.lds + LDS_LIST) + F.wave * 128;
    volatile LAS unsigned* qw = (volatile LAS unsigned*)(F.lds + MISC_OFF + 64);
    for (;;) {
        if (F.tid == 0) qw[0] = __hip_atomic_fetch_add(qctr, 1u, __ATOMIC_RELAXED, __HIP_MEMORY_SCOPE_AGENT);
        __syncthreads();
        const unsigned ui = qw[0];
        if (ui >= 32u * NBLK) break;
        const int n = (int)(ui >> 5), bh = (int)(ui & 31), b = bh >> 3, h = bh & 7;
#pragma unroll
        for (int j = 0; j < 4; ++j) { const int idx = F.tid + 512 * j; const int row = idx >> 3, ch = idx & 7;
            const u32x4 kv = *(const u32x4*)(Kb + ((size_t)b * SEQ + n * 256 + row) * AW + h * 64 + ch * 8);
            *(LAS u32x4*)(Ks + row * KS_STRIDE + ch * 16) = kv;
            const int d = idx >> 5, c2 = idx & 31;
            const u32x4 vv = *(const u32x4*)(VT + ((size_t)bh * HD + d) * SEQ + n * 256 + c2 * 8);
            *(LAS u32x4*)(Vs + d * VS_STRIDE + c2 * 16) = vv; }
        __syncthreads();
        { const int j = 7 - F.wave; const int qi = 32 * j + (F.lane & 31);
          attn_tile(Q, Ks, Vs, h, (size_t)b * SEQ + n * 256 + qi, true, j + 1, j, qi, P, LSE, 3, F.lane); }
        const int t0 = 256 * (n + 1), nq = SEQ - t0; int pending = 0;
        for (int base = F.wave * 64; base < nq; base += 512) {
            const int t = t0 + base + F.lane;
            const unsigned msk = sel[(size_t)bh * SEQ + t];
            const bool bit = (msk >> n) & 1u;
            const unsigned long long bal = __ballot(bit);
            if (bit) { const int pos = pending + __popcll(bal & ((1ull << F.lane) - 1ull)); lst[pos] = t | (__popc(msk & ((1u << n) - 1u)) << 16); }
            pending += __popcll(bal);
            while (pending >= 32) {
                const int e = lst[F.lane & 31];
                attn_tile(Q, Ks, Vs, h, (size_t)b * SEQ + (e & 0xffff), true, 8, -1, 0, P, LSE, e >> 16, F.lane);
                const int keep = lst[F.lane + 32]; lst[F.lane] = keep; pending -= 32;
            }
        }
        if (pending > 0) { const int sl = F.lane & 31; const int e = lst[sl < pending ? sl : 0];
            attn_tile(Q, Ks, Vs, h, (size_t)b * SEQ + (e & 0xffff), sl < pending, 8, -1, 0, P, LSE, e >> 16, F.lane); }
        __syncthreads();
    }
}
__device__ __forceinline__ void combine_phase() {
    const Frame F = make_frame(); const KArgs a = kargs();
    const bf16* P = (const bf16*)(a->ws + WS_PBUF); const float* LSE = (const float*)(a->ws + WS_LSE); bf16* ATT = (bf16*)(a->ws + WS_ATT);
    for (int i = F.bid * 512 + F.tid; i < M * 64; i += F.G * 512) { const int ch = i & 7, h = (i >> 3) & 7, r = i >> 6; const int m = (r & (SEQ - 1)) >> 8; const int nv = m < 3 ? m : 3;
        const f32x4 l4 = *(const f32x4*)(LSE + ((size_t)r * NH + h) * 4);
        float mx = l4[3]; if (nv > 0) mx = fmaxf(mx, l4[0]); if (nv > 1) mx = fmaxf(mx, l4[1]); if (nv > 2) mx = fmaxf(mx, l4[2]);
        float w[4]; w[0] = nv > 0 ? __builtin_amdgcn_exp2f(l4[0] - mx) : 0.f; w[1] = nv > 1 ? __builtin_amdgcn_exp2f(l4[1] - mx) : 0.f; w[2] = nv > 2 ? __builtin_amdgcn_exp2f(l4[2] - mx) : 0.f; w[3] = __builtin_amdgcn_exp2f(l4[3] - mx);
        const float inv = 1.0f / ((w[0] + w[1]) + (w[2] + w[3]));
        float o[8] = {0.f, 0.f, 0.f, 0.f, 0.f, 0.f, 0.f, 0.f};
        const bf16* pp = P + (((size_t)r * NH + h) * 4) * 64 + 8 * ch;
#pragma unroll
        for (int s = 0; s < 4; ++s) if (s == 3 || s < nv) { float f[8]; unpack8(*(const u32x4*)(pp + s * 64), f);
#pragma unroll
            for (int e = 0; e < 8; ++e) o[e] += w[s] * f[e]; }
#pragma unroll
        for (int e = 0; e < 8; ++e) o[e] *= inv;
        *(u32x4*)(ATT + (size_t)r * AW + h * 64 + 8 * ch) = pack8(o); }
}
__device__ __forceinline__ void conv_phase() {
    const Frame F = make_frame(); const KArgs a = kargs();
    const bf16* UP = (const bf16*)(a->ws + WS_UPH); bf16* ACT = (bf16*)(a->ws + WS_ACTH); const float* cw = a->in[17]; const float* cb = a->in[18];
    constexpr int NCC = FF / 8;
    for (int i = F.bid * 512 + F.tid; i < (HALFM / 8) * NCC; i += F.G * 512) { const int cc = i % NCC, rg = i / NCC; const int c = 8 * cc, r0 = 8 * rg; const bool first = ((r0 & (SEQ - 1)) == 0);
        float wv[3][8], wg[3][8], bv[8], bg[8];
#pragma unroll
        for (int j = 0; j < 3; ++j) { *(f32x4*)&wv[j][0] = *(const f32x4*)(cw + j * FF2 + c); *(f32x4*)&wv[j][4] = *(const f32x4*)(cw + j * FF2 + c + 4);
            *(f32x4*)&wg[j][0] = *(const f32x4*)(cw + j * FF2 + FF + c); *(f32x4*)&wg[j][4] = *(const f32x4*)(cw + j * FF2 + FF + c + 4); }
        *(f32x4*)&bv[0] = *(const f32x4*)(cb + c); *(f32x4*)&bv[4] = *(const f32x4*)(cb + c + 4); *(f32x4*)&bg[0] = *(const f32x4*)(cb + FF + c); *(f32x4*)&bg[4] = *(const f32x4*)(cb + FF + c + 4);
        float v2[8], v1[8], g2[8], g1[8];
        if (first) {
#pragma unroll
            for (int e = 0; e < 8; ++e) { v2[e] = 0.f; v1[e] = 0.f; g2[e] = 0.f; g1[e] = 0.f; }
        } else { unpack8(*(const u32x4*)(UP + (size_t)(r0 - 2) * FF2 + c), v2); unpack8(*(const u32x4*)(UP + (size_t)(r0 - 1) * FF2 + c), v1);
                 unpack8(*(const u32x4*)(UP + (size_t)(r0 - 2) * FF2 + FF + c), g2); unpack8(*(const u32x4*)(UP + (size_t)(r0 - 1) * FF2 + FF + c), g1); }
#pragma unroll
        for (int k = 0; k < 8; ++k) { float v0[8], g0[8], o[8]; unpack8(*(const u32x4*)(UP + (size_t)(r0 + k) * FF2 + c), v0); unpack8(*(const u32x4*)(UP + (size_t)(r0 + k) * FF2 + FF + c), g0);
#pragma unroll
            for (int e = 0; e < 8; ++e) { const float vc = bv[e] + wv[0][e] * v2[e] + wv[1][e] * v1[e] + wv[2][e] * v0[e]; const float gc = bg[e] + wg[0][e] * g2[e] + wg[1][e] * g1[e] + wg[2][e] * g0[e];
                o[e] = gelu_tanh(gc) * vc; v2[e] = v1[e]; v1[e] = v0[e]; g2[e] = g1[e]; g1[e] = g0[e]; }
            *(u32x4*)(ACT + (size_t)(r0 + k) * FF + c) = pack8(o); } }
}

__global__ void __launch_bounds__(512, 2) fwd_megakernel(Args args) {
    cg::grid_group grid = cg::this_grid();
#define PHASE_SETUP const Frame F = make_frame(); const KArgs ka = kargs(); unsigned char* ws = ka->ws; LAS unsigned* lnflag = (LAS unsigned*)(F.lds + MISC_OFF); (void)lnflag
    p0_prologue();
    grid.sync();
    { PHASE_SETUP; Gemm g{(const char*)(ws + WS_XB), (const char*)(ws + WS_WIN), D, D, D}; SchedPlain S; S.so.init(M, INW, F.G, F.bid); S.astep = 256L * D * 2; S.bstep = 256L * D * 2;
      EpiInProj E{(bf16*)(ws + WS_Q), (bf16*)(ws + WS_K), (bf16*)(ws + WS_VT), (bf16*)(ws + WS_UA), (bf16*)(ws + WS_GA), (bf16*)(ws + WS_GS), (const f32x2*)(ws + WS_ROPE)};
      pg8::gemm_phase(F.lds, g, S, E); }
    ssm_weights();
    grid.sync();
    { PHASE_SETUP; Gemm g{(const char*)(ws + WS_UA), (const char*)(ws + WS_WE), 256, UROW, 256}; SchedGroup S{F.G, F.bid, 256L * UROW * 2, 256L * 256 * 2};
      EpiE E{(float*)(ws + WS_E)}; pg8::gemm_phase(F.lds, g, S, E); }
    kmean_phase();
    grid.sync();
    scan_phase();
    select_phase();
    grid.sync();
    { PHASE_SETUP; Gemm g{(const char*)(ws + WS_UA), (const char*)(ws + WS_WY), UROW, UROW, UROW}; SchedGroup S{F.G, F.bid, 256L * UROW * 2, 256L * UROW * 2};
      EpiY E{(const bf16*)(ws + WS_UA), ka->in[10], (bf16*)(ws + WS_Y)}; pg8::gemm_phase(F.lds, g, S, E); }
    attn_phase();
    grid.sync();
    { PHASE_SETUP; Gemm g{(const char*)(ws + WS_Y), (const char*)(ws + WS_WGLU), SW, SW, SW}; SchedPlain S; S.so.init(M, SW, F.G, F.bid); S.astep = 256L * SW * 2; S.bstep = 256L * SW * 2;
      EpiGLU E{(const bf16*)(ws + WS_Y), (bf16*)(ws + WS_SSMO)}; pg8::gemm_phase(F.lds, g, S, E); }
    combine_phase();
    grid.sync();
    { PHASE_SETUP; Gemm g{(const char*)(ws + WS_ATT), (const char*)(ws + WS_WAP), AW, AW, AW}; SchedPair S; S.so.init(M, D, F.G, F.bid); S.astep = 256L * AW * 2; S.bstep = 256L * AW * 2;
      S.a1off = (long)WS_SSMO - (long)WS_ATT; S.b1off = (long)WS_WSP - (long)WS_WAP;
      EpiMerge E{(const bf16*)(ws + WS_GA), (const bf16*)(ws + WS_GS), (bf16*)(ws + WS_MERGED)}; pg8::gemm_phase(F.lds, g, S, E); }
    grid.sync();
    { PHASE_SETUP; Gemm g{(const char*)(ws + WS_MERGED), (const char*)(ws + WS_WOUT), D, D, D}; SchedPlain S; S.so.init(M, D, F.G, F.bid); S.astep = 256L * D * 2; S.bstep = 256L * D * 2;
      EpiLN E{ka->in[0], ka->out, (bf16*)(ws + WS_H1B), ka->in[14], ka->in[15], (unsigned*)(ws + WS_CTL) + CW_LN1, lnflag, 0}; pg8::gemm_phase(F.lds, g, S, E); }
    grid.sync();
    for (int hf = 0; hf < 2; ++hf) {
        { PHASE_SETUP; Gemm g{(const char*)(ws + WS_H1B) + (size_t)hf * HALFM * D * 2, (const char*)(ws + WS_WUP), D, D, D}; SchedPlain S; S.so.init(HALFM, FF2, F.G, F.bid); S.astep = 256L * D * 2; S.bstep = 256L * D * 2;
          EpiBf16 E{(bf16*)(ws + WS_UPH), FF2}; pg8::gemm_phase(F.lds, g, S, E); }
        grid.sync();
        conv_phase();
        grid.sync();
        { PHASE_SETUP; Gemm g{(const char*)(ws + WS_ACTH), (const char*)(ws + WS_WDN), FF, FF, FF}; SchedPlain S; S.so.init(HALFM, D, F.G, F.bid); S.astep = 256L * FF * 2; S.bstep = 256L * FF * 2;
          EpiLN E{ka->out, ka->out, nullptr, ka->in[20], ka->in[21], (unsigned*)(ws + WS_CTL) + CW_LN2, lnflag, hf * HALFM}; pg8::gemm_phase(F.lds, g, S, E); }
        if (hf == 0) grid.sync();
    }
#undef PHASE_SETUP
}

extern "C" void kernel_launch(void* const* d_in, const int* in_sizes, int n_in, void* d_out, int out_size, void* d_ws, size_t ws_size, hipStream_t stream) {
    static int grid = 0;
    if (grid == 0) {
        if (n_in != 22 || in_sizes[0] != M * D || out_size != M * D || ws_size < WS_END) { fprintf(stderr, "kernel_launch: unexpected shapes (n_in %d, in0 %d, out %d, ws %zu); nothing launched\n", n_in, n_in > 0 ? in_sizes[0] : -1, out_size, ws_size); grid = -1; return; }
        int dev = 0, cus = 0, per_cu = 0;
        if (hipGetDevice(&dev) != hipSuccess || hipDeviceGetAttribute(&cus, hipDeviceAttributeMultiprocessorCount, dev) != hipSuccess) { grid = -1; return; }
        if (hipFuncSetAttribute((const void*)fwd_megakernel, hipFuncAttributeMaxDynamicSharedMemorySize, LDS_BYTES) != hipSuccess) { fprintf(stderr, "kernel_launch: hipFuncSetAttribute failed\n"); grid = -1; return; }
        if (hipOccupancyMaxActiveBlocksPerMultiprocessor(&per_cu, (const void*)fwd_megakernel, 512, LDS_BYTES) != hipSuccess || per_cu < 1) { fprintf(stderr, "kernel_launch: occupancy query failed (%d)\n", per_cu); (void)hipGetLastError(); grid = -1; return; }
        grid = cus * per_cu;
        if (grid < 128) { fprintf(stderr, "kernel_launch: grid %d too small\n", grid); grid = -1; return; }
    }
    if (grid < 0) return;
    if (hipMemsetAsync((char*)d_ws + WS_CTL, 0, CTL_BYTES, stream) != hipSuccess) { fprintf(stderr, "kernel_launch: memset failed\n"); return; }
    Args a{};
    for (int i = 0; i < 22; ++i) a.in[i] = (const float*)d_in[i];
    a.out = (float*)d_out; a.ws = (unsigned char*)d_ws;
    void* kargs[] = {&a};
    const hipError_t e = hipLaunchCooperativeKernel((const void*)fwd_megakernel, dim3(grid), dim3(512), kargs, LDS_BYTES, stream);
    if (e != hipSuccess) fprintf(stderr, "kernel_launch: cooperative launch failed: %s (grid %d)\n", hipGetErrorString(e), grid);
}
```
